# Optimizing an MI355X kernel written in HIP

```python
import jax, jax.numpy as jnp
from jax import lax
import numpy as np

D_MODEL = 1024
BATCH = 8
SEQ = 2048
DEPTH = 1

M_HEADS = 4
M_DQK = 128
M_DV = 128
M_CHUNK = 64
CONV_W = 4
F_HEADS = 8
F_DH = 64
Q_BLOCK = 128
N_EXPERTS = 32
TOP_K = 4
D_FF = D_MODEL
SWIGLU_ALPHA = 1.702
SWIGLU_LIMIT = 7.0
MOE_BLOCK = 256
DN_ALPHA = (2.0 * DEPTH) ** 0.25
DN_BETA = (8.0 * DEPTH) ** -0.25
LN_EPS = 1e-5

M_W = M_HEADS * M_DV
F_W = F_HEADS * F_DH
MQK_W = 2 * M_HEADS * M_DQK
MQK_OFF = 0
MV_OFF = MQK_OFF + MQK_W
MO_OFF = MV_OFF + M_W
MI_OFF = MO_OFF + M_W
MF_OFF = MI_OFF + M_HEADS
FQ_OFF = MF_OFF + M_HEADS
FK_OFF = FQ_OFF + F_W
FV_OFF = FK_OFF + F_W
FF_OFF = FV_OFF + F_W
GM_OFF = FF_OFF + F_HEADS
GF_OFF = GM_OFF + D_MODEL
IN_COLS = GF_OFF + D_MODEL
SPLIT_IDX = (MV_OFF, MO_OFF, MI_OFF, MF_OFF, FQ_OFF, FK_OFF, FV_OFF, FF_OFF, GM_OFF, GF_OFF)

kernel_name = "hybrid_mlstm_fox_moe_deepnorm"


def layer_norm(x, g, b):
    xf = x.astype(jnp.float32)
    mu = jnp.mean(xf, -1, keepdims=True)
    var = jnp.mean(jnp.square(xf - mu), -1, keepdims=True)
    return ((xf - mu) * lax.rsqrt(var + LN_EPS)).astype(x.dtype) * g + b


def head_layer_norm(h):
    mu = jnp.mean(h, -1, keepdims=True)
    var = jnp.mean(jnp.square(h - mu), -1, keepdims=True)
    return (h - mu) * lax.rsqrt(var + LN_EPS)


def causal_depthwise_conv(u, w, b):
    c = u.shape[-1]
    y = lax.conv_general_dilated(u, w[:, None, :].astype(u.dtype), window_strides=(1,),
                                 padding=[(CONV_W - 1, 0)],
                                 dimension_numbers=("NWC", "WIO", "NWC"),
                                 feature_group_count=c)
    return y + b


def to_heads(t, n_heads):
    bsz, s, _ = t.shape
    return t.reshape(bsz, s, n_heads, -1).transpose(0, 2, 1, 3)


def mlstm_chunkwise(q, k, v, i_pre, logf):
    f32 = jnp.float32
    q, k, v = q.astype(f32), k.astype(f32), v.astype(f32)
    i_pre, logf = i_pre.astype(f32), logf.astype(f32)
    bsz, nh, s, dk = q.shape
    dv = v.shape[-1]
    L = M_CHUNK
    n = s // L
    q = q.reshape(bsz, nh, n, L, dk)
    k = k.reshape(bsz, nh, n, L, dk)
    v = v.reshape(bsz, nh, n, L, dv)
    i_pre = i_pre.reshape(bsz, nh, n, L)
    logf = logf.reshape(bsz, nh, n, L)

    b = jnp.cumsum(logf, axis=-1)
    g = b[..., -1]
    a = g[..., None] - b + i_pre
    m_loc = jnp.max(a, axis=-1)
    causal = jnp.tril(jnp.ones((L, L), dtype=bool))
    dlog = jnp.where(causal, b[..., :, None] - b[..., None, :] + i_pre[..., None, :], -jnp.inf)

    def step(carry, xs):
        c_st, n_st, m_st = carry
        k_c, v_c, a_c, g_c, ml_c = xs
        m_new = jnp.maximum(g_c + m_st, ml_c)
        decay = jnp.exp(g_c + m_st - m_new)
        w = jnp.exp(a_c - m_new[..., None])
        c_new = decay[..., None, None] * c_st + jnp.einsum('bhl,bhlk,bhlv->bhkv', w, k_c, v_c)
        n_new = decay[..., None] * n_st + jnp.einsum('bhl,bhlk->bhk', w, k_c)
        return (c_new, n_new, m_new), (c_st, n_st, m_st)

    init = (jnp.zeros((bsz, nh, dk, dv), f32), jnp.zeros((bsz, nh, dk), f32), jnp.zeros((bsz, nh), f32))
    xs = (jnp.moveaxis(k, 2, 0), jnp.moveaxis(v, 2, 0), jnp.moveaxis(a, 2, 0),
          jnp.moveaxis(g, 2, 0), jnp.moveaxis(m_loc, 2, 0))
    _, (c_prev, n_prev, m_prev) = lax.scan(step, init, xs)
    c_prev = jnp.moveaxis(c_prev, 0, 2)
    n_prev = jnp.moveaxis(n_prev, 0, 2)
    m_prev = jnp.moveaxis(m_prev, 0, 2)

    inter_log = b + m_prev[..., None]
    m_t = jnp.maximum(inter_log, jnp.max(dlog, axis=-1))
    w_inter = jnp.exp(inter_log - m_t)
    w_intra = jnp.exp(dlog - m_t[..., None])
    qk = jnp.einsum('bhntd,bhnsd->bhnts', q, k) * w_intra
    num = (w_inter[..., None] * jnp.einsum('bhntk,bhnkv->bhntv', q, c_prev)
           + jnp.einsum('bhnts,bhnsv->bhntv', qk, v))
    den = w_inter * jnp.einsum('bhntk,bhnk->bhnt', q, n_prev) + jnp.sum(qk, axis=-1)
    h = num / jnp.maximum(jnp.abs(den), jnp.exp(-m_t))[..., None]
    return h.reshape(bsz, nh, s, dv)


def forgetting_attention(q, k, v, logf):
    f32 = jnp.float32
    s_len = q.shape[2]
    scale = q.shape[-1] ** -0.5
    c = jnp.cumsum(logf.astype(f32), axis=-1)
    outs = []
    for blk in range(s_len // Q_BLOCK):
        q0 = blk * Q_BLOCK
        q1 = q0 + Q_BLOCK
        sc = jnp.einsum('bhtd,bhsd->bhts', q[:, :, q0:q1], k[:, :, :q1],
                        preferred_element_type=f32) * scale
        sc = sc + c[:, :, q0:q1, None] - c[:, :, None, :q1]
        mask = (q0 + jnp.arange(Q_BLOCK))[:, None] >= jnp.arange(q1)[None, :]
        p = jax.nn.softmax(jnp.where(mask, sc, -jnp.inf), axis=-1)
        outs.append(jnp.einsum('bhts,bhsd->bhtd', p.astype(v.dtype), v[:, :, :q1]))
    return jnp.concatenate(outs, axis=2)


def hybrid_mixer(h, w_in, b_in, m_conv_w, m_conv_b, m_norm_g, w_bm, w_bf, w_o):
    bsz, s, _ = h.shape
    proj = jnp.einsum('bsd,dc->bsc', h, w_in) + b_in
    mqk, mv, mo, mi, mf, fq, fk, fv, ff, gm, gf = jnp.split(proj, SPLIT_IDX, axis=-1)

    mqk = jax.nn.silu(causal_depthwise_conv(mqk, m_conv_w, m_conv_b))
    mq, mk = jnp.split(mqk, 2, axis=-1)
    hm = mlstm_chunkwise(to_heads(mq, M_HEADS), to_heads(mk, M_HEADS) * (M_DQK ** -0.5),
                         to_heads(mv, M_HEADS),
                         mi.astype(jnp.float32).transpose(0, 2, 1),
                         jax.nn.log_sigmoid(mf.astype(jnp.float32)).transpose(0, 2, 1))
    hm = head_layer_norm(hm).transpose(0, 2, 1, 3).reshape(bsz, s, M_W).astype(h.dtype) * m_norm_g
    hm = jax.nn.sigmoid(mo) * hm

    hf = forgetting_attention(to_heads(fq, F_HEADS), to_heads(fk, F_HEADS), to_heads(fv, F_HEADS),
                              jax.nn.log_sigmoid(ff.astype(jnp.float32)).transpose(0, 2, 1))
    hf = hf.transpose(0, 2, 1, 3).reshape(bsz, s, F_W)

    y = jax.nn.sigmoid(gm) * (hm @ w_bm) + jax.nn.sigmoid(gf) * (hf @ w_bf)
    return y @ w_o


def moe_ffn(h, w_router, b_router, w_gu, b_gu, w_dn, b_dn):
    bsz, s, d = h.shape
    t = bsz * s
    xt = h.reshape(t, d)
    logits = (xt @ w_router + b_router).astype(jnp.float32)
    top_v, top_e = lax.top_k(logits, TOP_K)
    gate = jax.nn.softmax(top_v, axis=-1)

    n_assign = t * TOP_K
    e_flat = top_e.reshape(n_assign).astype(jnp.int32)
    tok_flat = jnp.repeat(jnp.arange(t, dtype=jnp.int32), TOP_K)
    g_flat = gate.reshape(n_assign)
    order = jnp.argsort(e_flat)
    e_sorted = e_flat[order]
    counts = jnp.bincount(e_flat, length=N_EXPERTS).astype(jnp.int32)
    start = jnp.cumsum(counts) - counts
    padded = ((counts + MOE_BLOCK - 1) // MOE_BLOCK) * MOE_BLOCK
    pad_end = jnp.cumsum(padded)
    pad_start = pad_end - padded
    dest = pad_start[e_sorted] + (jnp.arange(n_assign, dtype=jnp.int32) - start[e_sorted])
    n_blocks = -(-n_assign // MOE_BLOCK) + N_EXPERTS
    n_rows = n_blocks * MOE_BLOCK
    row_tok = jnp.full((n_rows,), t, jnp.int32).at[dest].set(tok_flat[order])
    row_gate = jnp.zeros((n_rows,), jnp.float32).at[dest].set(g_flat[order])
    block_e = jnp.minimum(jnp.searchsorted(pad_end, jnp.arange(n_blocks, dtype=jnp.int32) * MOE_BLOCK,
                                           side='right'), N_EXPERTS - 1)

    def expert_block(args):
        tok_b, e = args
        xb = xt[jnp.minimum(tok_b, t - 1)]
        gu = xb @ w_gu[e] + b_gu[e]
        x_glu, x_lin = jnp.split(gu, 2, axis=-1)
        x_glu = jnp.minimum(x_glu, SWIGLU_LIMIT)
        x_lin = jnp.clip(x_lin, -SWIGLU_LIMIT, SWIGLU_LIMIT)
        act = x_glu * jax.nn.sigmoid(SWIGLU_ALPHA * x_glu) * (x_lin + 1.0)
        return act @ w_dn[e] + b_dn[e]

    y_rows = lax.map(expert_block, (row_tok.reshape(n_blocks, MOE_BLOCK), block_e)).reshape(n_rows, d)
    y = jax.ops.segment_sum(y_rows * row_gate[:, None].astype(y_rows.dtype), row_tok, num_segments=t)
    return y.reshape(bsz, s, d)


def setup_inputs(seed: int = 0) -> dict:
    key = jax.random.key(seed)
    ks = jax.random.split(key, 20)
    L, D, E, F = DEPTH, D_MODEL, N_EXPERTS, D_FF

    def nrm(k, shape, scale):
        return jax.random.normal(k, shape, jnp.float32) * scale

    col_scale = np.ones((IN_COLS,), np.float32)
    col_scale[MV_OFF:MV_OFF + M_W] = DN_BETA
    col_scale[FV_OFF:FV_OFF + F_W] = DN_BETA
    b_off = np.zeros((IN_COLS,), np.float32)
    b_off[MF_OFF:MF_OFF + M_HEADS] = np.linspace(3.0, 6.0, M_HEADS)
    b_off[FF_OFF:FF_OFF + F_HEADS] = np.linspace(1.0, 5.0, F_HEADS)

    x = nrm(ks[0], (BATCH, SEQ, D), 1.0)
    w_in = nrm(ks[1], (L, D, IN_COLS), D ** -0.5) * jnp.asarray(col_scale)
    b_in = nrm(ks[2], (L, IN_COLS), 0.02) + jnp.asarray(b_off)
    m_conv_w = nrm(ks[3], (L, CONV_W, MQK_W), CONV_W ** -0.5)
    m_conv_b = nrm(ks[4], (L, MQK_W), 0.02)
    m_norm_g = 1.0 + nrm(ks[5], (L, M_W), 0.02)
    w_bm = nrm(ks[6], (L, M_W, D), DN_BETA * M_W ** -0.5)
    w_bf = nrm(ks[7], (L, F_W, D), DN_BETA * F_W ** -0.5)
    w_o = nrm(ks[8], (L, D, D), DN_BETA * D ** -0.5)
    ln1_g = 1.0 + nrm(ks[9], (L, D), 0.02)
    ln1_b = nrm(ks[10], (L, D), 0.02)
    w_router = nrm(ks[11], (L, D, E), D ** -0.5)
    b_router = nrm(ks[12], (L, E), 0.01)
    w_gu = nrm(ks[13], (L, E, D, 2 * F), DN_BETA * D ** -0.5)
    b_gu = nrm(ks[14], (L, E, 2 * F), 0.02)
    w_dn = nrm(ks[15], (L, E, F, D), DN_BETA * F ** -0.5)
    b_dn = nrm(ks[16], (L, E, D), 0.02)
    ln2_g = 1.0 + nrm(ks[17], (L, D), 0.02)
    ln2_b = nrm(ks[18], (L, D), 0.02)
    return {"x": x, "w_in": w_in, "b_in": b_in, "m_conv_w": m_conv_w, "m_conv_b": m_conv_b,
            "m_norm_g": m_norm_g, "w_bm": w_bm, "w_bf": w_bf, "w_o": w_o,
            "ln1_g": ln1_g, "ln1_b": ln1_b, "w_router": w_router, "b_router": b_router,
            "w_gu": w_gu, "b_gu": b_gu, "w_dn": w_dn, "b_dn": b_dn,
            "ln2_g": ln2_g, "ln2_b": ln2_b}


def reference(x, w_in, b_in, m_conv_w, m_conv_b, m_norm_g, w_bm, w_bf, w_o, ln1_g, ln1_b,
              w_router, b_router, w_gu, b_gu, w_dn, b_dn, ln2_g, ln2_b):
    h = x
    for l in range(DEPTH):
        mix = hybrid_mixer(h, w_in[l], b_in[l], m_conv_w[l], m_conv_b[l], m_norm_g[l],
                           w_bm[l], w_bf[l], w_o[l])
        h = layer_norm(DN_ALPHA * h + mix, ln1_g[l], ln1_b[l])
        ffn = moe_ffn(h, w_router[l], b_router[l], w_gu[l], b_gu[l], w_dn[l], b_dn[l])
        h = layer_norm(DN_ALPHA * h + ffn, ln2_g[l], ln2_b[l])
    return h
```

```cpp
#include <hip/hip_runtime.h>
#include <cstdint>
#include <cstdio>

constexpr int D = 1024, BATCH = 8, SEQ = 2048, T = BATCH * SEQ;
constexpr int NE = 32, TOPK = 4;
constexpr int MV_OFF = 1024, MO_OFF = 1536, MI_OFF = 2048, MF_OFF = 2052, FQ_OFF = 2056, FK_OFF = 2568, FV_OFF = 3080,
              FF_OFF = 3592, GM_OFF = 3600, GF_OFF = 4624, IN_COLS = 5648;
constexpr float DN_ALPHA = 1.189207115002721f, LN_EPS = 1e-5f;

__device__ __forceinline__ float sigmoidf_(float x) { return 1.f / (1.f + expf(-x)); }
__device__ __forceinline__ float logsigmoidf_(float x) { return fminf(x, 0.f) - log1pf(expf(-fabsf(x))); }

__global__ __launch_bounds__(256) void gemm_f32(const float* __restrict__ A, int lda, const float* __restrict__ B, int ldb, float* __restrict__ C, int ldc,
                                                const float* __restrict__ bias, int M, int N, int K) {
    __shared__ float As[16][68], Bs[16][68];
    const int tid = threadIdx.x, tx = tid & 15, ty = tid >> 4;
    const int m0 = blockIdx.y * 64, n0 = blockIdx.x * 64;
    float acc[4][4];
#pragma unroll
    for (int i = 0; i < 4; ++i)
#pragma unroll
        for (int j = 0; j < 4; ++j) acc[i][j] = 0.f;
    for (int k0 = 0; k0 < K; k0 += 16) {
#pragma unroll
        for (int i = 0; i < 4; ++i) {
            const int idx = tid + i * 256;
            { const int r = idx >> 4, kk = idx & 15; As[kk][r] = A[(size_t)(m0 + r) * lda + k0 + kk]; }
            { const int kk = idx >> 6, c = idx & 63; Bs[kk][c] = (n0 + c < N) ? B[(size_t)(k0 + kk) * ldb + n0 + c] : 0.f; }
        }
        __syncthreads();
#pragma unroll
        for (int kk = 0; kk < 16; ++kk) {
            float a[4], b[4];
#pragma unroll
            for (int i = 0; i < 4; ++i) { a[i] = As[kk][ty * 4 + i]; b[i] = Bs[kk][tx * 4 + i]; }
#pragma unroll
            for (int i = 0; i < 4; ++i)
#pragma unroll
                for (int j = 0; j < 4; ++j) acc[i][j] += a[i] * b[j];
        }
        __syncthreads();
    }
#pragma unroll
    for (int i = 0; i < 4; ++i)
#pragma unroll
        for (int j = 0; j < 4; ++j) {
            const int r = m0 + ty * 4 + i, c = n0 + tx * 4 + j;
            if (c < N) C[(size_t)r * ldc + c] = acc[i][j] + (bias ? bias[c] : 0.f);
        }
}

__global__ void conv_silu(const float* __restrict__ proj, const float* __restrict__ cw, const float* __restrict__ cb, float* __restrict__ qkc) {
    const int idx = blockIdx.x * blockDim.x + threadIdx.x;
    const int t = idx >> 10, c = idx & 1023, s = t & (SEQ - 1);
    float y = cb[c];
#pragma unroll
    for (int k = 0; k < 4; ++k) { const int ss = s - 3 + k; if (ss >= 0) y += cw[k * 1024 + c] * proj[(size_t)(t - 3 + k) * IN_COLS + c]; }
    qkc[idx] = y * sigmoidf_(y);
}

__global__ __launch_bounds__(1024) void mlstm_rec(const float* __restrict__ qkc, const float* __restrict__ proj, const float* __restrict__ norm_g, float* __restrict__ hm) {
    const int bh = blockIdx.x, b = bh >> 2, h = bh & 3;
    const int tid = threadIdx.x, k = tid >> 3, v0 = (tid & 7) * 16, wave = tid >> 6, lane = tid & 63;
    __shared__ float sq[128], sk[128], sv[128], part[16][128], sden[16];
    float C[16];
#pragma unroll
    for (int j = 0; j < 16; ++j) C[j] = 0.f;
    float nk = 0.f, m = 0.f;
    for (int t = 0; t < SEQ; ++t) {
        const size_t row = (size_t)b * SEQ + t;
        if (tid < 128) {
            sq[tid] = qkc[row * 1024 + h * 128 + tid];
            sk[tid] = qkc[row * 1024 + 512 + h * 128 + tid] * 0.08838834764831845f;
            sv[tid] = proj[row * IN_COLS + MV_OFF + h * 128 + tid];
        }
        const float ip = proj[row * IN_COLS + MI_OFF + h], fp = proj[row * IN_COLS + MF_OFF + h];
        const float logf = logsigmoidf_(fp);
        const float m_new = fmaxf(logf + m, ip);
        const float fd = expf(logf + m - m_new), iw = expf(ip - m_new);
        m = m_new;
        __syncthreads();
        const float kk = sk[k], qq = sq[k];
        nk = fd * nk + iw * kk;
        float p[16];
#pragma unroll
        for (int j = 0; j < 16; ++j) { C[j] = fd * C[j] + iw * kk * sv[v0 + j]; p[j] = C[j] * qq; }
        float dp = nk * qq;
#pragma unroll
        for (int o = 8; o < 64; o <<= 1) {
#pragma unroll
            for (int j = 0; j < 16; ++j) p[j] += __shfl_xor(p[j], o);
            dp += __shfl_xor(dp, o);
        }
        if (lane < 8) {
#pragma unroll
            for (int j = 0; j < 16; ++j) part[wave][v0 + j] = p[j];
        }
        if (lane == 0) sden[wave] = dp;
        __syncthreads();
        if (tid < 64) {
            float num0 = 0.f, num1 = 0.f, den = 0.f;
#pragma unroll
            for (int w = 0; w < 16; ++w) { num0 += part[w][tid]; num1 += part[w][tid + 64]; den += sden[w]; }
            const float dn = fmaxf(fabsf(den), expf(-m));
            const float h0 = num0 / dn, h1 = num1 / dn;
            float s = h0 + h1;
#pragma unroll
            for (int o = 1; o < 64; o <<= 1) s += __shfl_xor(s, o);
            const float mu = s * (1.f / 128.f);
            const float d0 = h0 - mu, d1 = h1 - mu;
            float q = d0 * d0 + d1 * d1;
#pragma unroll
            for (int o = 1; o < 64; o <<= 1) q += __shfl_xor(q, o);
            const float rs = rsqrtf(q * (1.f / 128.f) + LN_EPS);
            const int c0 = h * 128 + tid, c1 = c0 + 64;
            hm[row * 512 + c0] = d0 * rs * norm_g[c0] * sigmoidf_(proj[row * IN_COLS + MO_OFF + c0]);
            hm[row * 512 + c1] = d1 * rs * norm_g[c1] * sigmoidf_(proj[row * IN_COLS + MO_OFF + c1]);
        }
    }
}

__global__ void fox_cumsum(const float* __restrict__ proj, float* __restrict__ cf) {
    const int bh = blockIdx.x * blockDim.x + threadIdx.x;
    if (bh >= BATCH * 8) return;
    const int b = bh >> 3, h = bh & 7;
    float c = 0.f;
    for (int s = 0; s < SEQ; ++s) { c += logsigmoidf_(proj[(size_t)(b * SEQ + s) * IN_COLS + FF_OFF + h]); cf[bh * SEQ + s] = c; }
}

__global__ __launch_bounds__(256) void fox_attn(const float* __restrict__ proj, const float* __restrict__ cf, float* __restrict__ hf) {
    __shared__ float sc[4][SEQ];
    const int wave = threadIdx.x >> 6, lane = threadIdx.x & 63;
    const int gid = blockIdx.x * 4 + wave;
    const int t = gid & (SEQ - 1), bh = gid >> 11, b = bh >> 3, h = bh & 7;
    const float* qrow = proj + (size_t)(b * SEQ + t) * IN_COLS + FQ_OFF + h * 64;
    float q[64];
#pragma unroll
    for (int d = 0; d < 64; d += 4) { const float4 v = *(const float4*)(qrow + d); q[d] = v.x; q[d + 1] = v.y; q[d + 2] = v.z; q[d + 3] = v.w; }
    const float ct = cf[bh * SEQ + t];
    float mx = -INFINITY;
    for (int s = lane; s <= t; s += 64) {
        const float* krow = proj + (size_t)(b * SEQ + s) * IN_COLS + FK_OFF + h * 64;
        float dot = 0.f;
#pragma unroll
        for (int d = 0; d < 64; d += 4) { const float4 v = *(const float4*)(krow + d); dot += q[d] * v.x + q[d + 1] * v.y + q[d + 2] * v.z + q[d + 3] * v.w; }
        const float sv = dot * 0.125f + ct - cf[bh * SEQ + s];
        sc[wave][s] = sv; mx = fmaxf(mx, sv);
    }
#pragma unroll
    for (int o = 1; o < 64; o <<= 1) mx = fmaxf(mx, __shfl_xor(mx, o));
    float sum = 0.f;
    for (int s = lane; s <= t; s += 64) { const float p = expf(sc[wave][s] - mx); sc[wave][s] = p; sum += p; }
#pragma unroll
    for (int o = 1; o < 64; o <<= 1) sum += __shfl_xor(sum, o);
    __builtin_amdgcn_s_waitcnt(0);
    float o_ = 0.f;
    for (int s = 0; s <= t; ++s) o_ += sc[wave][s] * proj[(size_t)(b * SEQ + s) * IN_COLS + FV_OFF + h * 64 + lane];
    hf[(size_t)(b * SEQ + t) * 512 + h * 64 + lane] = o_ / sum;
}

__global__ void gate_combine(const float* __restrict__ proj, float* __restrict__ t1, const float* __restrict__ t2) {
    const int idx = blockIdx.x * blockDim.x + threadIdx.x;
    const int t = idx >> 10, c = idx & 1023;
    const float gm = sigmoidf_(proj[(size_t)t * IN_COLS + GM_OFF + c]), gf = sigmoidf_(proj[(size_t)t * IN_COLS + GF_OFF + c]);
    t1[idx] = gm * t1[idx] + gf * t2[idx];
}

__device__ __forceinline__ float block_sum256(float v, float* red) {
#pragma unroll
    for (int o = 1; o < 64; o <<= 1) v += __shfl_xor(v, o);
    __syncthreads();
    if ((threadIdx.x & 63) == 0) red[threadIdx.x >> 6] = v;
    __syncthreads();
    return red[0] + red[1] + red[2] + red[3];
}

__global__ __launch_bounds__(256) void ln_res(const float* __restrict__ base, const float* __restrict__ add, const float* __restrict__ g, const float* __restrict__ bb, float* __restrict__ out) {
    __shared__ float red[4];
    const size_t row = blockIdx.x; const int c = threadIdx.x * 4;
    const float4 xb = *(const float4*)(base + row * D + c), xa = *(const float4*)(add + row * D + c);
    float v[4] = {DN_ALPHA * xb.x + xa.x, DN_ALPHA * xb.y + xa.y, DN_ALPHA * xb.z + xa.z, DN_ALPHA * xb.w + xa.w};
    const float mu = block_sum256(v[0] + v[1] + v[2] + v[3], red) * (1.f / D);
    float q = 0.f;
#pragma unroll
    for (int i = 0; i < 4; ++i) { v[i] -= mu; q += v[i] * v[i]; }
    const float rs = rsqrtf(block_sum256(q, red) * (1.f / D) + LN_EPS);
#pragma unroll
    for (int i = 0; i < 4; ++i) out[row * D + c + i] = v[i] * rs * g[c + i] + bb[c + i];
}

__global__ void route(const float* __restrict__ logits, int* __restrict__ counts, int* __restrict__ tok_list, int* __restrict__ asg_e, int* __restrict__ asg_slot, float* __restrict__ gate) {
    const int t = blockIdx.x * blockDim.x + threadIdx.x;
    if (t >= T) return;
    float l[NE];
#pragma unroll
    for (int e = 0; e < NE; ++e) l[e] = logits[(size_t)t * NE + e];
    int sel[TOPK]; float val[TOPK];
#pragma unroll
    for (int k = 0; k < TOPK; ++k) {
        int bi = 0; float bv = -INFINITY;
#pragma unroll
        for (int e = 0; e < NE; ++e) { if (l[e] > bv) { bv = l[e]; bi = e; } }
        sel[k] = bi; val[k] = bv;
#pragma unroll
        for (int e = 0; e < NE; ++e) if (e == bi) l[e] = -INFINITY;
    }
    float s = 0.f, p[TOPK];
#pragma unroll
    for (int k = 0; k < TOPK; ++k) { p[k] = expf(val[k] - val[0]); s += p[k]; }
#pragma unroll
    for (int k = 0; k < TOPK; ++k) {
        const int slot = atomicAdd(&counts[sel[k]], 1);
        tok_list[sel[k] * T + slot] = t;
        asg_e[t * TOPK + k] = sel[k]; asg_slot[t * TOPK + k] = slot; gate[t * TOPK + k] = p[k] / s;
    }
}
__global__ void moe_offsets(const int* __restrict__ counts, int* __restrict__ starts) {
    if (threadIdx.x == 0) { int a = 0; for (int e = 0; e < NE; ++e) { starts[e] = a; a += counts[e]; } }
}

__global__ __launch_bounds__(256) void moe_gemm1(const float* __restrict__ h1, const float* __restrict__ w_gu, const float* __restrict__ b_gu, const int* __restrict__ counts,
                                                 const int* __restrict__ starts, const int* __restrict__ tok_list, float* __restrict__ act) {
    const int e = blockIdx.z, cnt = counts[e], r0 = blockIdx.y * 64;
    if (r0 >= cnt) return;
    __shared__ float As[16][68], Bg[16][68], Bl[16][68];
    __shared__ int toks[64];
    const int tid = threadIdx.x, tx = tid & 15, ty = tid >> 4, n0 = blockIdx.x * 64;
    if (tid < 64) toks[tid] = tok_list[e * T + min(r0 + tid, cnt - 1)];
    __syncthreads();
    const float* W = w_gu + (size_t)e * D * 2048;
    float ag[4][4], al[4][4];
#pragma unroll
    for (int i = 0; i < 4; ++i)
#pragma unroll
        for (int j = 0; j < 4; ++j) { ag[i][j] = 0.f; al[i][j] = 0.f; }
    for (int k0 = 0; k0 < D; k0 += 16) {
#pragma unroll
        for (int i = 0; i < 4; ++i) {
            const int idx = tid + i * 256;
            { const int r = idx >> 4, kk = idx & 15; As[kk][r] = h1[(size_t)toks[r] * D + k0 + kk]; }
            { const int kk = idx >> 6, c = idx & 63; Bg[kk][c] = W[(size_t)(k0 + kk) * 2048 + n0 + c]; Bl[kk][c] = W[(size_t)(k0 + kk) * 2048 + 1024 + n0 + c]; }
        }
        __syncthreads();
#pragma unroll
        for (int kk = 0; kk < 16; ++kk) {
            float a[4], bg[4], bl[4];
#pragma unroll
            for (int i = 0; i < 4; ++i) { a[i] = As[kk][ty * 4 + i]; bg[i] = Bg[kk][tx * 4 + i]; bl[i] = Bl[kk][tx * 4 + i]; }
#pragma unroll
            for (int i = 0; i < 4; ++i)
#pragma unroll
                for (int j = 0; j < 4; ++j) { ag[i][j] += a[i] * bg[j]; al[i][j] += a[i] * bl[j]; }
        }
        __syncthreads();
    }
    const int st = starts[e];
#pragma unroll
    for (int i = 0; i < 4; ++i) {
        const int r = r0 + ty * 4 + i;
        if (r < cnt) {
#pragma unroll
            for (int j = 0; j < 4; ++j) {
                const int c = n0 + tx * 4 + j;
                float g = ag[i][j] + b_gu[e * 2048 + c], l = al[i][j] + b_gu[e * 2048 + 1024 + c];
                g = fminf(g, 7.f); l = fminf(fmaxf(l, -7.f), 7.f);
                act[(size_t)(st + r) * 1024 + c] = g * sigmoidf_(1.702f * g) * (l + 1.f);
            }
        }
    }
}
__global__ __launch_bounds__(256) void moe_gemm2(const float* __restrict__ act, const float* __restrict__ w_dn, const float* __restrict__ b_dn, const int* __restrict__ counts,
                                                 const int* __restrict__ starts, float* __restrict__ yrows) {
    const int e = blockIdx.z, cnt = counts[e], r0 = blockIdx.y * 64;
    if (r0 >= cnt) return;
    __shared__ float As[16][68], Bs[16][68];
    const int tid = threadIdx.x, tx = tid & 15, ty = tid >> 4, n0 = blockIdx.x * 64;
    const int st = starts[e];
    const float* W = w_dn + (size_t)e * 1024 * D;
    float acc[4][4];
#pragma unroll
    for (int i = 0; i < 4; ++i)
#pragma unroll
        for (int j = 0; j < 4; ++j) acc[i][j] = 0.f;
    for (int k0 = 0; k0 < 1024; k0 += 16) {
#pragma unroll
        for (int i = 0; i < 4; ++i) {
            const int idx = tid + i * 256;
            { const int r = idx >> 4, kk = idx & 15; As[kk][r] = act[(size_t)(st + min(r0 + r, cnt - 1)) * 1024 + k0 + kk]; }
            { const int kk = idx >> 6, c = idx & 63; Bs[kk][c] = W[(size_t)(k0 + kk) * D + n0 + c]; }
        }
        __syncthreads();
#pragma unroll
        for (int kk = 0; kk < 16; ++kk) {
            float a[4], b[4];
#pragma unroll
            for (int i = 0; i < 4; ++i) { a[i] = As[kk][ty * 4 + i]; b[i] = Bs[kk][tx * 4 + i]; }
#pragma unroll
            for (int i = 0; i < 4; ++i)
#pragma unroll
                for (int j = 0; j < 4; ++j) acc[i][j] += a[i] * b[j];
        }
        __syncthreads();
    }
#pragma unroll
    for (int i = 0; i < 4; ++i) {
        const int r = r0 + ty * 4 + i;
        if (r < cnt) {
#pragma unroll
            for (int j = 0; j < 4; ++j) { const int c = n0 + tx * 4 + j; yrows[(size_t)(st + r) * D + c] = acc[i][j] + b_dn[e * D + c]; }
        }
    }
}
__global__ __launch_bounds__(256) void final_ln(const float* __restrict__ h1, const float* __restrict__ yrows, const int* __restrict__ starts, const int* __restrict__ asg_e,
                                                const int* __restrict__ asg_slot, const float* __restrict__ gate, const float* __restrict__ g, const float* __restrict__ bb, float* __restrict__ out) {
    __shared__ float red[4];
    const size_t row = blockIdx.x; const int c = threadIdx.x * 4;
    const float4 xb = *(const float4*)(h1 + row * D + c);
    float f[4] = {0.f, 0.f, 0.f, 0.f};
#pragma unroll
    for (int k = 0; k < TOPK; ++k) {
        const int e = asg_e[row * TOPK + k], pos = starts[e] + asg_slot[row * TOPK + k]; const float gt = gate[row * TOPK + k];
        const float4 y = *(const float4*)(yrows + (size_t)pos * D + c);
        f[0] += gt * y.x; f[1] += gt * y.y; f[2] += gt * y.z; f[3] += gt * y.w;
    }
    float v[4] = {DN_ALPHA * xb.x + f[0], DN_ALPHA * xb.y + f[1], DN_ALPHA * xb.z + f[2], DN_ALPHA * xb.w + f[3]};
    const float mu = block_sum256(v[0] + v[1] + v[2] + v[3], red) * (1.f / D);
    float q = 0.f;
#pragma unroll
    for (int i = 0; i < 4; ++i) { v[i] -= mu; q += v[i] * v[i]; }
    const float rs = rsqrtf(block_sum256(q, red) * (1.f / D) + LN_EPS);
#pragma unroll
    for (int i = 0; i < 4; ++i) out[row * D + c + i] = v[i] * rs * g[c + i] + bb[c + i];
}

extern "C" void kernel_launch(void* const* d_in, const int* in_sizes, int n_in, void* d_out, int out_size, void* d_ws, size_t ws_size, hipStream_t stream) {
    const float* x = (const float*)d_in[0]; const float* w_in = (const float*)d_in[1]; const float* b_in = (const float*)d_in[2];
    const float* cw = (const float*)d_in[3]; const float* cb = (const float*)d_in[4]; const float* norm_g = (const float*)d_in[5];
    const float* w_bm = (const float*)d_in[6]; const float* w_bf = (const float*)d_in[7]; const float* w_o = (const float*)d_in[8];
    const float* ln1_g = (const float*)d_in[9]; const float* ln1_b = (const float*)d_in[10]; const float* w_router = (const float*)d_in[11];
    const float* b_router = (const float*)d_in[12]; const float* w_gu = (const float*)d_in[13]; const float* b_gu = (const float*)d_in[14];
    const float* w_dn = (const float*)d_in[15]; const float* b_dn = (const float*)d_in[16]; const float* ln2_g = (const float*)d_in[17]; const float* ln2_b = (const float*)d_in[18];
    float* out = (float*)d_out;
    char* ws = (char*)d_ws; const size_t MiB = 1u << 20;
    float* PROJ = (float*)(ws); float* ACT = PROJ;
    float* QKC = (float*)(ws + 384 * MiB); float* HM = (float*)(ws + 448 * MiB); float* HF = (float*)(ws + 480 * MiB);
    float* H1 = (float*)(ws + 512 * MiB); float* YROWS = (float*)(ws + 576 * MiB); float* TMP1 = YROWS; float* TMP2 = (float*)(ws + 640 * MiB);
    char* sm = ws + 832 * MiB;
    float* LOGITS = (float*)sm; int* TOKL = (int*)(sm + 2 * MiB); int* ASGE = (int*)(sm + 4 * MiB); int* ASGS = (int*)(sm + 5 * MiB);
    float* GATE = (float*)(sm + 6 * MiB); float* CF = (float*)(sm + 7 * MiB); int* COUNTS = (int*)(sm + 8 * MiB); int* STARTS = COUNTS + 64;

    hipMemsetAsync(COUNTS, 0, 512, stream);
    gemm_f32<<<dim3((IN_COLS + 63) / 64, T / 64), 256, 0, stream>>>(x, D, w_in, IN_COLS, PROJ, IN_COLS, b_in, T, IN_COLS, D);
    conv_silu<<<T * 1024 / 256, 256, 0, stream>>>(PROJ, cw, cb, QKC);
    mlstm_rec<<<BATCH * 4, 1024, 0, stream>>>(QKC, PROJ, norm_g, HM);
    fox_cumsum<<<1, 64, 0, stream>>>(PROJ, CF);
    fox_attn<<<BATCH * 8 * SEQ / 4, 256, 0, stream>>>(PROJ, CF, HF);
    gemm_f32<<<dim3(D / 64, T / 64), 256, 0, stream>>>(HM, 512, w_bm, D, TMP1, D, nullptr, T, D, 512);
    gemm_f32<<<dim3(D / 64, T / 64), 256, 0, stream>>>(HF, 512, w_bf, D, TMP2, D, nullptr, T, D, 512);
    gate_combine<<<T * 1024 / 256, 256, 0, stream>>>(PROJ, TMP1, TMP2);
    gemm_f32<<<dim3(D / 64, T / 64), 256, 0, stream>>>(TMP1, D, w_o, D, TMP2, D, nullptr, T, D, D);
    ln_res<<<T, 256, 0, stream>>>(x, TMP2, ln1_g, ln1_b, H1);
    gemm_f32<<<dim3(1, T / 64), 256, 0, stream>>>(H1, D, w_router, NE, LOGITS, NE, b_router, T, NE, D);
    route<<<T / 256, 256, 0, stream>>>(LOGITS, COUNTS, TOKL, ASGE, ASGS, GATE);
    moe_offsets<<<1, 64, 0, stream>>>(COUNTS, STARTS);
    moe_gemm1<<<dim3(1024 / 64, T / 64, NE), 256, 0, stream>>>(H1, w_gu, b_gu, COUNTS, STARTS, TOKL, ACT);
    moe_gemm2<<<dim3(D / 64, T / 64, NE), 256, 0, stream>>>(ACT, w_dn, b_dn, COUNTS, STARTS, YROWS);
    final_ln<<<T, 256, 0, stream>>>(H1, YROWS, STARTS, ASGE, ASGS, GATE, ln2_g, ln2_b, out);
}
```
